# Optimizing an MI355X kernel written in HIP

```python
import math
import jax, jax.numpy as jnp
from jax import lax
import numpy as np

D_MODEL = 1024
BATCH = 8
SEQ = 4096
DEPTH = 1

CHUNK = 64
EPS = 1e-6
PLE_DIM = 256
POOL_W = D_MODEL
POOL_WINDOWS = (2, 4, 8, 16)
POOL_GROUPS = len(POOL_WINDOWS)
POOL_GROUP_W = POOL_W // POOL_GROUPS
RET_HEADS = 4
RET_QK_HEAD = D_MODEL // RET_HEADS
RET_V_HEAD = 2 * RET_QK_HEAD
RET_QK_W = RET_HEADS * RET_QK_HEAD
RET_V_W = RET_HEADS * RET_V_HEAD
ROPE_BASE = 10000.0
IN_SPLITS = (POOL_W, RET_QK_W, RET_QK_W, RET_V_W, RET_V_W, D_MODEL, D_MODEL)
IN_W = sum(IN_SPLITS)
N_EXPERTS = 32
TOP_K = 4
D_FF = D_MODEL
SWIGLU_ALPHA = 1.702
SWIGLU_LIMIT = 7.0
MOE_BLOCK = 256

kernel_name = "hybrid_pool_retention_moe_block"


def _rmsnorm(x, g):
    x32 = x.astype(jnp.float32)
    y = x32 * lax.rsqrt(jnp.mean(x32 * x32, axis=-1, keepdims=True) + EPS)
    return (y * g.astype(jnp.float32)).astype(x.dtype)


def _multiscale_pool(u, w_pool, scale):
    b, s, _ = u.shape
    u32 = u.astype(jnp.float32).reshape(b, s, POOL_GROUPS, POOL_GROUP_W)
    cs = jnp.cumsum(u32, axis=1)
    t = jnp.arange(s, dtype=jnp.float32)
    outs = []
    for g, w in enumerate(POOL_WINDOWS):
        cg = cs[:, :, g]
        lag = jnp.pad(cg, ((0, 0), (w, 0), (0, 0)))[:, :s]
        count = jnp.minimum(t + 1.0, float(w))[None, :, None]
        pooled = (cg - lag) / count - u32[:, :, g]
        outs.append(jnp.einsum('bsc,cd->bsd', pooled.astype(u.dtype), w_pool[g]))
    return jnp.concatenate(outs, axis=-1) * scale


def _rotary(x, pos):
    half = x.shape[-1] // 2
    inv = ROPE_BASE ** (-jnp.linspace(0.0, 1.0, half, dtype=jnp.float32))
    ang = pos[:, None] * inv[None, :]
    cos = jnp.cos(ang)[None, :, None, :]
    sin = jnp.sin(ang)[None, :, None, :]
    x1, x2 = x[..., :half], x[..., half:]
    return jnp.concatenate([x1 * cos - x2 * sin, x2 * cos + x1 * sin], axis=-1)


def _retention(q, k, v):
    b, s, h, dk = q.shape
    dv = v.shape[-1]
    nc = s // CHUNK
    log_g = jnp.log(1.0 - 2.0 ** (-5.0 - jnp.arange(h, dtype=jnp.float32)))
    idx = jnp.arange(CHUNK, dtype=jnp.float32)
    intra = jnp.exp(log_g[:, None, None] * jnp.abs(idx[:, None] - idx[None, :]))
    q_dec = jnp.exp(log_g[:, None] * (idx + 1.0))[:, :, None]
    k_dec = jnp.exp(log_g[:, None] * (CHUNK - 1.0 - idx))[:, :, None]
    c_dec = jnp.exp(log_g * CHUNK)[:, None, None]

    def to_chunks(t):
        return t.reshape(b, nc, CHUNK, h, t.shape[-1]).transpose(1, 0, 3, 2, 4)

    def step(state, inp):
        qc, kc, vc = inp
        scores = jnp.einsum('bhid,bhjd->bhij', qc, kc) * intra
        o = (jnp.einsum('bhij,bhjv->bhiv', scores, vc)
             + jnp.einsum('bhid,bhdv->bhiv', qc * q_dec, state))
        state = state * c_dec + jnp.einsum('bhjd,bhjv->bhdv', kc * k_dec, vc)
        return state, o

    state0 = jnp.zeros((b, h, dk, dv), jnp.float32)
    _, o = lax.scan(step, state0, (to_chunks(q), to_chunks(k), to_chunks(v)))
    return o.transpose(1, 0, 3, 2, 4).reshape(b, s, h, dv)


def _moe(h2, w_router, b_router, w_gate_up, b_gate_up, w_down, b_down):
    t, d = h2.shape
    logits = h2.astype(jnp.float32) @ w_router.astype(jnp.float32) + b_router.astype(jnp.float32)
    top_v, top_i = lax.top_k(logits, TOP_K)
    gates = jax.nn.softmax(top_v, axis=-1)
    n_assign = t * TOP_K
    flat_e = top_i.reshape(-1)
    flat_tok = jnp.repeat(jnp.arange(t, dtype=jnp.int32), TOP_K)
    flat_w = gates.reshape(-1)
    order = jnp.argsort(flat_e)
    sorted_e = flat_e[order]
    counts = jnp.bincount(flat_e, length=N_EXPERTS)
    padded = ((counts + MOE_BLOCK - 1) // MOE_BLOCK) * MOE_BLOCK
    ends_pad = jnp.cumsum(padded)
    starts_pad = ends_pad - padded
    starts = jnp.cumsum(counts) - counts
    rank = jnp.arange(n_assign, dtype=jnp.int32) - starts[sorted_e]
    dest = starts_pad[sorted_e] + rank
    n_buf = n_assign + N_EXPERTS * MOE_BLOCK
    n_blocks = n_buf // MOE_BLOCK
    tok_buf = jnp.full((n_buf,), t, jnp.int32).at[dest].set(flat_tok[order])
    w_buf = jnp.zeros((n_buf,), jnp.float32).at[dest].set(flat_w[order])
    block_e = jnp.minimum(
        jnp.searchsorted(ends_pad, jnp.arange(n_blocks, dtype=ends_pad.dtype) * MOE_BLOCK, side='right'),
        N_EXPERTS - 1)
    h_pad = jnp.concatenate([h2, jnp.zeros((1, d), h2.dtype)], axis=0)

    def expert_block(args):
        tok, wts, e = args
        xb = h_pad[tok]
        gu = xb @ w_gate_up[e] + b_gate_up[e]
        glu, lin = gu[:, :D_FF], gu[:, D_FF:]
        glu = jnp.minimum(glu, SWIGLU_LIMIT)
        lin = jnp.clip(lin, -SWIGLU_LIMIT, SWIGLU_LIMIT)
        act = glu * jax.nn.sigmoid(SWIGLU_ALPHA * glu) * (lin + 1.0)
        y = act @ w_down[e] + b_down[e]
        return y.astype(jnp.float32) * wts[:, None]

    y_buf = lax.map(expert_block, (tok_buf.reshape(n_blocks, MOE_BLOCK),
                                   w_buf.reshape(n_blocks, MOE_BLOCK), block_e))
    out = jax.ops.segment_sum(y_buf.reshape(n_buf, d), tok_buf, num_segments=t + 1)[:t]
    return out.astype(h2.dtype)


def setup_inputs(seed: int = 0) -> dict:
    key = jax.random.key(seed)
    ks = jax.random.split(key, 20)
    f32 = jnp.float32

    def nrm(k, shape, fan_in):
        return jax.random.normal(k, shape, f32) * (fan_in ** -0.5)

    def gain(k, shape):
        return 1.0 + 0.05 * jax.random.normal(k, shape, f32)

    return {
        "x": jax.random.normal(ks[0], (BATCH, SEQ, D_MODEL), f32),
        "p": jax.random.normal(ks[1], (DEPTH, BATCH, SEQ, PLE_DIM), f32),
        "g_mix": gain(ks[2], (DEPTH, D_MODEL)),
        "w_in": nrm(ks[3], (DEPTH, D_MODEL, IN_W), D_MODEL),
        "w_pool": nrm(ks[4], (DEPTH, POOL_GROUPS, POOL_GROUP_W, POOL_GROUP_W), POOL_GROUP_W),
        "pool_scale": gain(ks[5], (DEPTH, POOL_W)),
        "w_ret_o": nrm(ks[6], (DEPTH, RET_V_W, D_MODEL), RET_V_W),
        "w_out": nrm(ks[7], (DEPTH, D_MODEL, D_MODEL), D_MODEL),
        "g_ffn": gain(ks[8], (DEPTH, D_MODEL)),
        "w_router": nrm(ks[9], (DEPTH, D_MODEL, N_EXPERTS), D_MODEL),
        "b_router": 0.01 * jax.random.normal(ks[10], (DEPTH, N_EXPERTS), f32),
        "w_gate_up": nrm(ks[11], (DEPTH, N_EXPERTS, D_MODEL, 2 * D_FF), D_MODEL),
        "b_gate_up": 0.02 * jax.random.normal(ks[12], (DEPTH, N_EXPERTS, 2 * D_FF), f32),
        "w_down": nrm(ks[13], (DEPTH, N_EXPERTS, D_FF, D_MODEL), D_FF),
        "b_down": 0.02 * jax.random.normal(ks[14], (DEPTH, N_EXPERTS, D_MODEL), f32),
        "g_ple": gain(ks[15], (DEPTH, D_MODEL)),
        "w_ple_gate": nrm(ks[16], (DEPTH, D_MODEL, D_MODEL), D_MODEL),
        "w_ple": nrm(ks[17], (DEPTH, PLE_DIM, D_MODEL), PLE_DIM),
        "g_final": gain(ks[18], (D_MODEL,)),
    }


def reference(x, p, g_mix, w_in, w_pool, pool_scale, w_ret_o, w_out,
              g_ffn, w_router, b_router, w_gate_up, b_gate_up, w_down, b_down,
              g_ple, w_ple_gate, w_ple, g_final):
    b, s, d = x.shape
    pos = jnp.arange(s, dtype=jnp.float32)
    split_at = list(np.cumsum(IN_SPLITS)[:-1])
    for i in range(DEPTH):
        h = _rmsnorm(x, g_mix[i])
        proj = h @ w_in[i]
        u_pool, q, k, v, g_ret, gate_a, gate_b = jnp.split(proj, split_at, axis=-1)
        y_pool = _multiscale_pool(u_pool, w_pool[i], pool_scale[i])
        q = _rotary(q.astype(jnp.float32).reshape(b, s, RET_HEADS, RET_QK_HEAD), pos)
        k = _rotary(k.astype(jnp.float32).reshape(b, s, RET_HEADS, RET_QK_HEAD), pos) * (RET_QK_HEAD ** -0.5)
        v = v.astype(jnp.float32).reshape(b, s, RET_HEADS, RET_V_HEAD)
        o = _retention(q, k, v)
        o = o * lax.rsqrt(jnp.mean(o * o, axis=-1, keepdims=True) + EPS)
        o = o.reshape(b, s, RET_V_W) * jax.nn.silu(g_ret.astype(jnp.float32))
        y_ret = o.astype(x.dtype) @ w_ret_o[i]
        merged = jax.nn.sigmoid(gate_a) * y_pool + jax.nn.sigmoid(gate_b) * y_ret
        x = x + merged @ w_out[i]
        h2 = _rmsnorm(x, g_ffn[i]).reshape(b * s, d)
        x = x + _moe(h2, w_router[i], b_router[i], w_gate_up[i], b_gate_up[i],
                     w_down[i], b_down[i]).reshape(b, s, d)
        u = _rmsnorm(x, g_ple[i])
        x = x + jax.nn.sigmoid(u @ w_ple_gate[i]) * (p[i] @ w_ple[i])
    return _rmsnorm(x, g_final)
```

```cpp
#include <hip/hip_runtime.h>
#include <hip/hip_cooperative_groups.h>
#include <cstdio>
#include <cstdint>
namespace cg = cooperative_groups;

#ifndef MK_N_LAUNCHES
#define MK_N_LAUNCHES 13
#endif
constexpr int N_PHASES = 13;

#define LAS __attribute__((address_space(3)))
typedef unsigned short bf16;
typedef short bf16x8 __attribute__((ext_vector_type(8)));
typedef short s16x4 __attribute__((ext_vector_type(4)));
typedef float f32x4 __attribute__((ext_vector_type(4)));
typedef float f32x2 __attribute__((ext_vector_type(2)));
typedef unsigned u32x4 __attribute__((ext_vector_type(4)));
typedef unsigned u32x2 __attribute__((ext_vector_type(2)));

constexpr int D = 1024, BATCH = 8, SEQ = 4096, T = BATCH * SEQ, PLE = 256, INW = 9216, NEXP = 32, TOPK = 4, DFF = 1024;
constexpr int RV_W = 2048;
constexpr float EPS = 1e-6f;
constexpr int MAXTILES = T * TOPK / 256 + NEXP;

constexpr size_t MiB = 1u << 20;
constexpr size_t WS_CTL = 0;
constexpr size_t CTL_BYTES = 4096;
constexpr size_t WS_WIN = 1 * MiB;
constexpr size_t WS_WPOOL = WS_WIN + 18 * MiB;
constexpr size_t WS_WPLE = WS_WPOOL + MiB / 2;
constexpr size_t WS_WRETO = WS_WPLE + MiB / 2;
constexpr size_t WS_WOUT = WS_WRETO + 4 * MiB;
constexpr size_t WS_WPG = WS_WOUT + 2 * MiB;
constexpr size_t WS_WGU = WS_WPG + 2 * MiB;
constexpr size_t WS_WDN = WS_WGU + 128 * MiB;
constexpr size_t WS_XN = WS_WDN + 64 * MiB;
constexpr size_t WS_PBF = WS_XN + 64 * MiB + 1 * MiB;
constexpr size_t WS_PE = WS_PBF + 16 * MiB;
constexpr size_t WS_TAB = WS_PE + 64 * MiB;
constexpr size_t WS_SSQ = WS_TAB + 4 * MiB;
constexpr size_t WS_TOKE = WS_SSQ + 8 * MiB;
constexpr size_t WS_GATEE = WS_TOKE + 4 * MiB;
constexpr size_t WS_ROUTE = WS_GATEE + 4 * MiB;
constexpr size_t WS_BIG = WS_ROUTE + 1 * MiB;
constexpr size_t B_UP = 0;
constexpr size_t B_Q = B_UP + 64 * MiB;
constexpr size_t B_K = B_Q + 64 * MiB;
constexpr size_t B_V = B_K + 64 * MiB;
constexpr size_t B_GR = B_V + 128 * MiB;
constexpr size_t B_GA = B_GR + 128 * MiB;
constexpr size_t B_GB = B_GA + 64 * MiB;
constexpr size_t B_END = B_GB + 64 * MiB;
constexpr size_t B_ACT = 0;
constexpr size_t B_Y = 272 * MiB;
constexpr size_t WS_END = WS_BIG + B_END;
static_assert(B_Y + 272 * MiB <= B_END, "MoE overlay");
static_assert(WS_END <= 1024 * MiB, "workspace map exceeds 1 GiB");

constexpr int RING_BYTES = 131072;
constexpr int MISC_OFF = RING_BYTES;
constexpr int MISC_TAB = MISC_OFF, MISC_TILEE = MISC_OFF + 2048, MISC_TBASE = MISC_TILEE + 2304, MISC_CNT = MISC_TBASE + 256;
constexpr int RT_W_BYTES = 1024 * 144;
constexpr int RT_MISC = RT_W_BYTES;
constexpr int LDS_BYTES = 155648;
static_assert(RT_MISC + 128 + 128 + 2048 + 2048 <= LDS_BYTES && MISC_CNT + 128 <= LDS_BYTES, "LDS map");

typedef __bf16 bf16x2_t __attribute__((ext_vector_type(2)));
__device__ __forceinline__ unsigned cvt_pk_bf16(float lo, float hi) { const f32x2 v = {lo, hi}; const bf16x2_t b = __builtin_convertvector(v, bf16x2_t); return __builtin_bit_cast(unsigned, b); }
__device__ __forceinline__ float bflo(unsigned u) { return __uint_as_float(u << 16); }
__device__ __forceinline__ float bfhi(unsigned u) { return __uint_as_float(u & 0xffff0000u); }
__device__ __forceinline__ float sigmoidf_(float x) { return __builtin_amdgcn_rcpf(1.0f + __expf(-x)); }
__device__ __forceinline__ float wave_sum(float v) {
#pragma unroll
    for (int o = 1; o < 64; o <<= 1) v += __shfl_xor(v, o);
    return v;
}

namespace pg8 {
constexpr int BM = 256, BK = 64, HALF = 128, HTB = HALF * BK * 2, STAGE_BYTES = 8 * HTB, NXCD = 8, WGM = 8;
__host__ __device__ __forceinline__ int lds_byte(int r, int c) { const int st = (r >> 4) * 2 + (c >> 5), rr = r & 15, cc = c & 31, ob = rr * 64 + cc * 2; return st * 1024 + (ob ^ (((ob >> 9) & 1) << 5)); }
__host__ __device__ __forceinline__ void stage_rc(int b, int& R, int& C) { const int st = b / 1024, sb = b % 1024, swz = sb ^ (((sb >> 9) & 1) << 5); R = (st >> 1) * 16 + swz / 64; C = (st & 1) * 32 + (swz % 64) / 2; }
__host__ __device__ __forceinline__ int perm32(int rho) { const int n = rho >> 4, i = rho & 15; return 8 * (i >> 2) + 4 * n + (i & 3); }

struct Unit { int pm, pn, aux; };

struct Order {
    int nM, nN, nwg, G, c;
    __device__ void init(int nM_, int nN_, int G_, int c_) { nM = nM_; nN = nN_; nwg = nM * nN; G = G_; c = c_; }
    __device__ bool next_mn(int i, Unit& u) const {
        const long L = (long)i * G + c; if (L >= nwg) return false;
        int wgid = (int)L; { const int q = nwg / NXCD, r = nwg % NXCD, xcd = wgid % NXCD, off = wgid / NXCD; wgid = (xcd < r ? xcd * (q + 1) : r * (q + 1) + (xcd - r) * q) + off; }
        const int nig = WGM * nN, gid = wgid / nig, fm = gid * WGM, gsz = (nM - fm) < WGM ? (nM - fm) : WGM;
        u.pm = fm + ((wgid % nig) % gsz); u.pn = (wgid % nig) / gsz; u.aux = 0; return true;
    }
};

struct SchedDense : Order {
    const char* A; const char* Bt; int lda, K, acol_per_pn;
    __device__ __forceinline__ bool next(int i, Unit& u) const { return next_mn(i, u); }
    __device__ __forceinline__ unsigned rowoff(const Unit& u, int row) const { return ((unsigned)(u.pm * BM + row) * (unsigned)lda + (unsigned)(u.pn * acol_per_pn)) * 2u; }
    __device__ __forceinline__ const char* bptr(const Unit& u) const { return Bt + (size_t)u.pn * BM * K * 2; }
};
struct SchedMoe : Order {
    const char* A; const char* Bt; int K, nrowsB;
    const int* tok_e;
    LAS const int* tile_e; LAS const int* tbase; LAS const int* cnt;
    __device__ __forceinline__ bool next(int i, Unit& u) const { if (!next_mn(i, u)) return false; u.aux = __builtin_amdgcn_readfirstlane(tile_e[u.pm]); return true; }
    __device__ __forceinline__ unsigned rowoff(const Unit& u, int row) const {
        if (!tok_e) return (unsigned)(u.pm * BM + row) * (unsigned)K * 2u;
        const int e = u.aux, rank = (u.pm - tbase[e]) * BM + row;
        const int tok = rank < cnt[e] ? tok_e[(size_t)e * T + rank] : T;
        return (unsigned)tok * (unsigned)K * 2u;
    }
    __device__ __forceinline__ const char* bptr(const Unit& u) const { return Bt + ((size_t)u.aux * nrowsB + (size_t)u.pn * BM) * K * 2; }
};

typedef f32x4 Acc[2][2][4][2];

struct EpiProj {
    static constexpr bool PERM = true;
    bf16* big; const float* COS; const float* SIN;
    __device__ __forceinline__ void operator()(const Acc& acc, const Unit& u, int wr, int wc, int fr, int fq) const {
        const int pn = u.pn; size_t boff; int ldc, colt; bool rot = false; float sc = 1.f;
        if (pn < 4) { boff = B_UP; ldc = 1024; colt = pn * 256; }
        else if (pn < 8) { boff = B_Q; ldc = 1024; colt = (pn - 4) * 256; rot = true; }
        else if (pn < 12) { boff = B_K; ldc = 1024; colt = (pn - 8) * 256; rot = true; sc = 0.0625f; }
        else if (pn < 20) { boff = B_V; ldc = 2048; colt = (pn - 12) * 256; }
        else if (pn < 28) { boff = B_GR; ldc = 2048; colt = (pn - 20) * 256; }
        else if (pn < 32) { boff = B_GA; ldc = 1024; colt = (pn - 28) * 256; }
        else { boff = B_GB; ldc = 1024; colt = (pn - 32) * 256; }
        bf16* base = (bf16*)((char*)big + boff);
        const int row0 = u.pm * BM + wr * 64 + fr, col0 = colt + wc * 32 + 8 * fq, j0 = wc * 32 + 8 * fq;
#pragma unroll
        for (int ai = 0; ai < 2; ++ai)
#pragma unroll
            for (int m = 0; m < 4; ++m) {
                const int row = row0 + ai * HALF + m * 16; bf16* rowp = base + (size_t)row * ldc + col0;
                f32x4 a0 = acc[ai][0][m][0], a1 = acc[ai][0][m][1], b0 = acc[ai][1][m][0], b1 = acc[ai][1][m][1];
                if (rot) {
                    const int pos = row & (SEQ - 1);
                    const f32x4 c0 = *(const f32x4*)(COS + pos * 128 + j0), c1 = *(const f32x4*)(COS + pos * 128 + j0 + 4);
                    const f32x4 s0 = *(const f32x4*)(SIN + pos * 128 + j0), s1 = *(const f32x4*)(SIN + pos * 128 + j0 + 4);
                    const f32x4 o0 = (a0 * c0 - b0 * s0) * sc, o1 = (a1 * c1 - b1 * s1) * sc, p0 = (b0 * c0 + a0 * s0) * sc, p1 = (b1 * c1 + a1 * s1) * sc;
                    a0 = o0; a1 = o1; b0 = p0; b1 = p1;
                }
                u32x4 w; w.x = cvt_pk_bf16(a0[0], a0[1]); w.y = cvt_pk_bf16(a0[2], a0[3]); w.z = cvt_pk_bf16(a1[0], a1[1]); w.w = cvt_pk_bf16(a1[2], a1[3]);
                *(u32x4*)(rowp) = w;
                w.x = cvt_pk_bf16(b0[0], b0[1]); w.y = cvt_pk_bf16(b0[2], b0[3]); w.z = cvt_pk_bf16(b1[0], b1[1]); w.w = cvt_pk_bf16(b1[2], b1[3]);
                *(u32x4*)(rowp + HALF) = w;
            }
    }
};
struct EpiGated {
    static constexpr bool PERM = true;
    bf16* O; const bf16* add; const bf16* gate;
    __device__ __forceinline__ void operator()(const Acc& acc, const Unit& u, int wr, int wc, int fr, int fq) const {
        const int row0 = u.pm * BM + wr * 64 + fr, col0 = u.pn * BM + wc * 32 + 8 * fq;
#pragma unroll
        for (int ai = 0; ai < 2; ++ai)
#pragma unroll
            for (int m = 0; m < 4; ++m) {
                const size_t off = (size_t)(row0 + ai * HALF + m * 16) * 1024 + col0;
#pragma unroll
                for (int bj = 0; bj < 2; ++bj) {
                    f32x4 v0 = acc[ai][bj][m][0], v1 = acc[ai][bj][m][1];
                    if (gate) { const u32x4 g = *(const u32x4*)(gate + off + bj * HALF);
                        v0[0] *= sigmoidf_(bflo(g.x)); v0[1] *= sigmoidf_(bfhi(g.x)); v0[2] *= sigmoidf_(bflo(g.y)); v0[3] *= sigmoidf_(bfhi(g.y));
                        v1[0] *= sigmoidf_(bflo(g.z)); v1[1] *= sigmoidf_(bfhi(g.z)); v1[2] *= sigmoidf_(bflo(g.w)); v1[3] *= sigmoidf_(bfhi(g.w)); }
                    if (add) { const u32x4 a = *(const u32x4*)(add + off + bj * HALF);
                        v0[0] += bflo(a.x); v0[1] += bfhi(a.x); v0[2] += bflo(a.y); v0[3] += bfhi(a.y);
                        v1[0] += bflo(a.z); v1[1] += bfhi(a.z); v1[2] += bflo(a.w); v1[3] += bfhi(a.w); }
                    u32x4 w; w.x = cvt_pk_bf16(v0[0], v0[1]); w.y = cvt_pk_bf16(v0[2], v0[3]); w.z = cvt_pk_bf16(v1[0], v1[1]); w.w = cvt_pk_bf16(v1[2], v1[3]);
                    *(u32x4*)(O + off + bj * HALF) = w;
                }
            }
    }
};
struct EpiResF32 {
    static constexpr bool PERM = false;
    const float* base; float* out; const bf16* pe;
    __device__ __forceinline__ void operator()(const Acc& acc, const Unit& u, int wr, int wc, int fr, int fq) const {
        const int row0 = u.pm * BM + wr * 64 + fr, col0 = u.pn * BM + wc * 32 + 4 * fq;
#pragma unroll
        for (int ai = 0; ai < 2; ++ai)
#pragma unroll
            for (int m = 0; m < 4; ++m) {
                const size_t off = (size_t)(row0 + ai * HALF + m * 16) * 1024 + col0;
#pragma unroll
                for (int bj = 0; bj < 2; ++bj)
#pragma unroll
                    for (int n = 0; n < 2; ++n) {
                        const size_t o = off + bj * HALF + n * 16; f32x4 v = acc[ai][bj][m][n];
                        if (pe) { const u32x2 p = *(const u32x2*)(pe + o);
                            v[0] = sigmoidf_(v[0]) * bflo(p.x); v[1] = sigmoidf_(v[1]) * bfhi(p.x); v[2] = sigmoidf_(v[2]) * bflo(p.y); v[3] = sigmoidf_(v[3]) * bfhi(p.y); }
                        *(f32x4*)(out + o) = *(const f32x4*)(base + o) + v;
                    }
            }
    }
};
struct EpiGateUp {
    static constexpr bool PERM = true;
    bf16* act; const float* bias;
    __device__ __forceinline__ void operator()(const Acc& acc, const Unit& u, int wr, int wc, int fr, int fq) const {
        const int row0 = u.pm * BM + wr * 64 + fr, j0 = u.pn * 128 + wc * 32 + 8 * fq;
        const float* bp = bias + (size_t)u.aux * 2048 + j0;
        const f32x4 bg0 = *(const f32x4*)(bp), bg1 = *(const f32x4*)(bp + 4), bl0 = *(const f32x4*)(bp + 1024), bl1 = *(const f32x4*)(bp + 1028);
#pragma unroll
        for (int ai = 0; ai < 2; ++ai)
#pragma unroll
            for (int m = 0; m < 4; ++m) {
                f32x4 g0 = acc[ai][0][m][0] + bg0, g1 = acc[ai][0][m][1] + bg1, l0 = acc[ai][1][m][0] + bl0, l1 = acc[ai][1][m][1] + bl1;
                f32x4 r0, r1;
#pragma unroll
                for (int e = 0; e < 4; ++e) {
                    float g = fminf(g0[e], 7.0f), l = fminf(fmaxf(l0[e], -7.0f), 7.0f); r0[e] = g * sigmoidf_(1.702f * g) * (l + 1.0f);
                    g = fminf(g1[e], 7.0f); l = fminf(fmaxf(l1[e], -7.0f), 7.0f); r1[e] = g * sigmoidf_(1.702f * g) * (l + 1.0f);
                }
                u32x4 w; w.x = cvt_pk_bf16(r0[0], r0[1]); w.y = cvt_pk_bf16(r0[2], r0[3]); w.z = cvt_pk_bf16(r1[0], r1[1]); w.w = cvt_pk_bf16(r1[2], r1[3]);
                *(u32x4*)(act + (size_t)(row0 + ai * HALF + m * 16) * 1024 + j0) = w;
            }
    }
};
struct EpiDown {
    static constexpr bool PERM = true;
    bf16* Y; const float* bias; const float* gate_e;
    LAS const int* tbase; LAS const int* cnt;
    __device__ __forceinline__ void operator()(const Acc& acc, const Unit& u, int wr, int wc, int fr, int fq) const {
        const int e = u.aux, rl0 = wr * 64 + fr, col0 = u.pn * BM + wc * 32 + 8 * fq;
        const float* bp = bias + (size_t)e * 1024 + col0;
        f32x4 bv[2][2];
#pragma unroll
        for (int bj = 0; bj < 2; ++bj) { bv[bj][0] = *(const f32x4*)(bp + bj * HALF); bv[bj][1] = *(const f32x4*)(bp + bj * HALF + 4); }
        const int rank0 = (u.pm - tbase[e]) * BM, ce = cnt[e];
#pragma unroll
        for (int ai = 0; ai < 2; ++ai)
#pragma unroll
            for (int m = 0; m < 4; ++m) {
                const int rl = rl0 + ai * HALF + m * 16, rank = rank0 + rl;
                const float gw = rank < ce ? gate_e[(size_t)e * T + rank] : 0.f;
                bf16* rowp = Y + (size_t)(u.pm * BM + rl) * 1024 + col0;
#pragma unroll
                for (int bj = 0; bj < 2; ++bj) {
                    const f32x4 v0 = (acc[ai][bj][m][0] + bv[bj][0]) * gw, v1 = (acc[ai][bj][m][1] + bv[bj][1]) * gw;
                    u32x4 w; w.x = cvt_pk_bf16(v0[0], v0[1]); w.y = cvt_pk_bf16(v0[2], v0[3]); w.z = cvt_pk_bf16(v1[0], v1[1]); w.w = cvt_pk_bf16(v1[2], v1[3]);
                    *(u32x4*)(rowp + bj * HALF) = w;
                }
            }
    }
};

template <class Epi, class Sched>
__device__ __forceinline__ void gemm_phase(LAS unsigned char* lds, const int K, const Sched& S, const Epi& E) {
    const int tid = threadIdx.x, wid = __builtin_amdgcn_readfirstlane(tid >> 6), lane = tid & 63, wr = wid >> 2, wc = wid & 3, fr = lane & 15, fq = lane >> 4;
    const int nt = K / BK;
    int Rr[2]; unsigned Cc2[2], voffB[2];
#pragma unroll
    for (int i = 0; i < 2; ++i) { int R, C; stage_rc(tid * 16 + i * 8192, R, C); const int Rb = Epi::PERM ? ((R & ~31) + perm32(R & 31)) : R;
        Rr[i] = R; Cc2[i] = (unsigned)C * 2u; voffB[i] = (unsigned)(Rb * K + C) * 2u; }
    const size_t kstep = (size_t)(BK * 2);
    const size_t hstep = (size_t)HALF * K * 2;
    const unsigned ldsw = (unsigned)wid * 1024u;
    const int aoff = lds_byte(wr * 64 + fr, fq * 8), boff = lds_byte(wc * 32 + fr, fq * 8);
    LAS unsigned* tab = (LAS unsigned*)(lds + MISC_TAB);
    const char* Ab = S.A;
#define PG8_SA(b, h) (((b) * 2 + (h)) * HTB)
#define PG8_SB(b, h) ((4 + (b) * 2 + (h)) * HTB)
#define PG8_STAGEB(bufoff, gbase) do { _Pragma("unroll") for (int _i = 0; _i < 2; ++_i) \
        __builtin_amdgcn_global_load_lds((const unsigned*)((const char*)(gbase) + voffB[_i]), (LAS unsigned*)(lds + (bufoff) + ldsw + _i * 8192), 16, 0, 0); } while (0)
#define PG8_STAGEA(bufoff, kb, off, h) do { _Pragma("unroll") for (int _i = 0; _i < 2; ++_i) \
        __builtin_amdgcn_global_load_lds((const unsigned*)(Ab + (kb) + (off)[h][_i]), (LAS unsigned*)(lds + (bufoff) + ldsw + _i * 8192), 16, 0, 0); } while (0)
#define PG8_LDA(dst, b, h) do { _Pragma("unroll") for (int m = 0; m < 4; ++m) _Pragma("unroll") for (int k = 0; k < 2; ++k) dst[m][k] = *(const LAS bf16x8*)(lds + PG8_SA(b, h) + aoff + m * 2048 + k * 1024); } while (0)
#define PG8_LDB(dst, b, h) do { _Pragma("unroll") for (int n = 0; n < 2; ++n) _Pragma("unroll") for (int k = 0; k < 2; ++k) dst[n][k] = *(const LAS bf16x8*)(lds + PG8_SB(b, h) + boff + n * 2048 + k * 1024); } while (0)
#define PG8_MMA(ai, bj, At, Bt) do { __builtin_amdgcn_s_setprio(1); _Pragma("unroll") for (int m = 0; m < 4; ++m) _Pragma("unroll") for (int n = 0; n < 2; ++n) _Pragma("unroll") for (int k = 0; k < 2; ++k) \
        acc[ai][bj][m][n] = __builtin_amdgcn_mfma_f32_16x16x32_bf16(Bt[n][k], At[m][k], acc[ai][bj][m][n], 0, 0, 0); __builtin_amdgcn_s_setprio(0); } while (0)
#define PG8_WAIT_V(n) asm volatile("s_waitcnt vmcnt(" #n ")" ::: "memory")
#define PG8_WAIT_L(n) asm volatile("s_waitcnt lgkmcnt(" #n ")" ::: "memory")
#define PG8_BAR __builtin_amdgcn_s_barrier()
#define PG8_SCHED __builtin_amdgcn_sched_barrier(0)
    Unit cur, nxt; int ui = 0;
    if (!S.next(0, cur)) return;
    Acc acc;
#pragma unroll
    for (int a = 0; a < 2; ++a)
#pragma unroll
        for (int b = 0; b < 2; ++b)
#pragma unroll
            for (int m = 0; m < 4; ++m)
#pragma unroll
                for (int n = 0; n < 2; ++n) acc[a][b][m][n] = (f32x4){0.f, 0.f, 0.f, 0.f};
    bf16x8 At[4][2], B0[2][2], B1[2][2];
    unsigned oc[2][2], on[2][2];
#pragma unroll
    for (int h = 0; h < 2; ++h)
#pragma unroll
        for (int i = 0; i < 2; ++i) { oc[h][i] = S.rowoff(cur, h * HALF + Rr[i]) + Cc2[i]; on[h][i] = oc[h][i]; }
    { Unit u1; const bool h1 = S.next(1, u1); if (tid < 256) tab[256 + tid] = h1 ? S.rowoff(u1, tid) : 0u; }
    const char* cB = S.bptr(cur);
    PG8_WAIT_L(0);
    PG8_STAGEB(PG8_SB(0, 0), cB); PG8_STAGEB(PG8_SB(0, 1), cB + hstep); PG8_STAGEA(PG8_SA(0, 0), 0, oc, 0); PG8_STAGEA(PG8_SA(0, 1), 0, oc, 1);
    if (wr == 1) PG8_BAR;
    PG8_WAIT_V(2); PG8_BAR;
    PG8_STAGEB(PG8_SB(1, 0), cB + kstep); PG8_STAGEA(PG8_SA(1, 0), kstep, oc, 0); PG8_STAGEB(PG8_SB(1, 1), cB + hstep + kstep);
    PG8_WAIT_V(6); PG8_BAR;
    for (;;) {
        const bool has_next = S.next(ui + 1, nxt);
        const char* nB = has_next ? S.bptr(nxt) : cB;
        for (int t = 0; t < nt; t += 2) {
            const bool last = (t == nt - 2);
            const size_t kb1 = (size_t)(t + 1) * kstep;
            size_t kb2; const char* b2; unsigned o2[2][2];
            if (last) {
                kb2 = 0; b2 = nB;
                if (has_next) {
#pragma unroll
                    for (int h = 0; h < 2; ++h)
#pragma unroll
                        for (int i = 0; i < 2; ++i) on[h][i] = tab[((ui + 1) & 1) * 256 + h * HALF + Rr[i]] + Cc2[i];
                }
#pragma unroll
                for (int h = 0; h < 2; ++h)
#pragma unroll
                    for (int i = 0; i < 2; ++i) o2[h][i] = on[h][i];
            } else {
                kb2 = (size_t)(t + 2) * kstep; b2 = cB + kb2;
#pragma unroll
                for (int h = 0; h < 2; ++h)
#pragma unroll
                    for (int i = 0; i < 2; ++i) o2[h][i] = oc[h][i];
            }
            const size_t kb3 = kb2 + kstep; const char* b3 = b2 + kstep;
            PG8_LDB(B0, 0, 0); PG8_LDB(B1, 0, 1); PG8_SCHED; PG8_LDA(At, 0, 0); PG8_STAGEA(PG8_SA(1, 1), kb1, oc, 1);
            PG8_WAIT_V(8); PG8_WAIT_L(0); PG8_BAR; PG8_MMA(0, 0, At, B0); PG8_MMA(0, 1, At, B1); PG8_BAR; PG8_SCHED;
            PG8_LDA(At, 0, 1); PG8_STAGEB(PG8_SB(0, 0), b2); PG8_STAGEB(PG8_SB(0, 1), b2 + hstep); PG8_STAGEA(PG8_SA(0, 0), kb2, o2, 0);
            PG8_WAIT_V(8); PG8_WAIT_L(0); PG8_BAR; PG8_MMA(1, 0, At, B0); PG8_MMA(1, 1, At, B1); PG8_BAR; PG8_SCHED;
            PG8_LDB(B0, 1, 0); PG8_LDB(B1, 1, 1); PG8_SCHED; PG8_LDA(At, 1, 0); PG8_STAGEA(PG8_SA(0, 1), kb2, o2, 1);
            PG8_WAIT_V(8); PG8_WAIT_L(0); PG8_BAR; PG8_MMA(0, 0, At, B0); PG8_MMA(0, 1, At, B1); PG8_BAR; PG8_SCHED;
            PG8_LDA(At, 1, 1); PG8_STAGEB(PG8_SB(1, 0), b3); PG8_STAGEB(PG8_SB(1, 1), b3 + hstep); PG8_STAGEA(PG8_SA(1, 0), kb3, o2, 0);
            PG8_WAIT_V(8); PG8_WAIT_L(0); PG8_BAR; PG8_MMA(1, 0, At, B0); PG8_MMA(1, 1, At, B1); PG8_BAR; PG8_SCHED;
        }
        if (wr == 0) PG8_BAR;
        E(acc, cur, wr, wc, fr, fq);
        { Unit u2; const bool h2 = S.next(ui + 2, u2); if (tid < 256) tab[(ui & 1) * 256 + tid] = h2 ? S.rowoff(u2, tid) : 0u; }
        if (!has_next) break;
#pragma unroll
        for (int a = 0; a < 2; ++a)
#pragma unroll
            for (int b = 0; b < 2; ++b)
#pragma unroll
                for (int m = 0; m < 4; ++m)
#pragma unroll
                    for (int n = 0; n < 2; ++n) acc[a][b][m][n] = (f32x4){0.f, 0.f, 0.f, 0.f};
        cur = nxt; cB = nB; ++ui;
#pragma unroll
        for (int h = 0; h < 2; ++h)
#pragma unroll
            for (int i = 0; i < 2; ++i) oc[h][i] = on[h][i];
        if (wr == 1) PG8_BAR;
    }
    PG8_WAIT_V(0);
    PG8_WAIT_L(0);
    PG8_BAR;
#undef PG8_SA
#undef PG8_SB
#undef PG8_STAGEA
#undef PG8_STAGEB
#undef PG8_LDA
#undef PG8_LDB
#undef PG8_MMA
#undef PG8_WAIT_V
#undef PG8_WAIT_L
#undef PG8_BAR
#undef PG8_SCHED
}
}

struct Args { const float* in[19]; float* out; unsigned char* ws; int ph_lo, ph_hi; };
struct Frame {
    LAS unsigned char* lds; int tid, lane, wave, vcu, G;
    const float* in[19]; float* out; unsigned char* ws;
};
#define WSP(T_, off) ((T_*)(F.ws + (off)))

__device__ __forceinline__ void p0_transpose_item(const float* W, int K, int N, bf16* WT, int k0, int n0, int drow0, const float* nscale, LAS float* scr, int lane) {
#pragma unroll 8
    for (int i = 0; i < 32; ++i) { const int kk = 2 * i + (lane >> 5); scr[kk * 33 + (lane & 31)] = W[(size_t)(k0 + kk) * N + n0 + (lane & 31)]; }
    asm volatile("s_waitcnt lgkmcnt(0)" ::: "memory");
    const int c = lane & 7;
#pragma unroll
    for (int j = 0; j < 4; ++j) { const int n = (lane >> 3) + 8 * j; const LAS float* s = scr + (8 * c) * 33 + n; const float sc = nscale ? nscale[n0 + n] : 1.0f;
        u32x4 o; o.x = cvt_pk_bf16(s[0 * 33] * sc, s[1 * 33] * sc); o.y = cvt_pk_bf16(s[2 * 33] * sc, s[3 * 33] * sc); o.z = cvt_pk_bf16(s[4 * 33] * sc, s[5 * 33] * sc); o.w = cvt_pk_bf16(s[6 * 33] * sc, s[7 * 33] * sc);
        *(u32x4*)(WT + (size_t)(drow0 + n) * K + k0 + 8 * c) = o; }
    asm volatile("s_waitcnt lgkmcnt(0)" ::: "memory");
}
__device__ __forceinline__ void rms_row_to_bf16(const float* xrow, const float* g, bf16* orow, int lane) {
    const f32x4* xr = (const f32x4*)xrow + lane; const f32x4* gr = (const f32x4*)g + lane;
    f32x4 v[4]; float s = 0.f;
#pragma unroll
    for (int j = 0; j < 4; ++j) { v[j] = xr[64 * j]; s += (v[j].x * v[j].x + v[j].y * v[j].y) + (v[j].z * v[j].z + v[j].w * v[j].w); }
    const float rstd = rsqrtf(wave_sum(s) * (1.f / D) + EPS);
    u32x2* o8 = (u32x2*)orow + lane;
#pragma unroll
    for (int j = 0; j < 4; ++j) { const f32x4 gg = gr[64 * j]; u32x2 o; o.x = cvt_pk_bf16(v[j].x * rstd * gg.x, v[j].y * rstd * gg.y); o.y = cvt_pk_bf16(v[j].z * rstd * gg.z, v[j].w * rstd * gg.w); o8[64 * j] = o; }
}

__device__ __forceinline__ void phase0(Frame& F) {
    LAS float* scr = (LAS float*)(F.lds + F.wave * 16384);
    const int gw = F.vcu * 8 + F.wave, NGW = F.G * 8, lane = F.lane;
    constexpr int I_IN = 16 * 288, I_POOL = 4 * 8 * 4, I_RETO = 32 * 32, I_OUT = 16 * 32, I_PG = 16 * 32, I_PLE = 4 * 32, I_GU = 16 * 64, I_DN = 16 * 32;
    constexpr int NITEMS = I_IN + I_POOL + I_RETO + I_OUT + I_PG + I_PLE + NEXP * I_GU + NEXP * I_DN;
    for (int it = gw; it < NITEMS; it += NGW) {
        int r = it;
        if (r < I_IN) { const int kb = r / 288, nb = r % 288; p0_transpose_item(F.in[3], 1024, INW, WSP(bf16, WS_WIN), kb * 64, nb * 32, nb * 32, nullptr, scr, lane); continue; } r -= I_IN;
        if (r < I_POOL) { const int g = r / 32, q = r % 32, kb = q / 8, nb = q % 8;
            p0_transpose_item(F.in[4] + (size_t)g * 65536, 256, 256, WSP(bf16, WS_WPOOL) + (size_t)g * 65536, kb * 64, nb * 32, nb * 32, F.in[5] + g * 256, scr, lane); continue; } r -= I_POOL;
        if (r < I_RETO) { const int kb = r / 32, nb = r % 32; p0_transpose_item(F.in[6], 2048, 1024, WSP(bf16, WS_WRETO), kb * 64, nb * 32, nb * 32, nullptr, scr, lane); continue; } r -= I_RETO;
        if (r < I_OUT) { const int kb = r / 32, nb = r % 32; p0_transpose_item(F.in[7], 1024, 1024, WSP(bf16, WS_WOUT), kb * 64, nb * 32, nb * 32, nullptr, scr, lane); continue; } r -= I_OUT;
        if (r < I_PG) { const int kb = r / 32, nb = r % 32; p0_transpose_item(F.in[16], 1024, 1024, WSP(bf16, WS_WPG), kb * 64, nb * 32, nb * 32, nullptr, scr, lane); continue; } r -= I_PG;
        if (r < I_PLE) { const int kb = r / 32, nb = r % 32; p0_transpose_item(F.in[17], 256, 1024, WSP(bf16, WS_WPLE), kb * 64, nb * 32, nb * 32, nullptr, scr, lane); continue; } r -= I_PLE;
        if (r < NEXP * I_GU) { const int e = r / I_GU, q = r % I_GU, kb = q / 64, nb = q % 64, n0 = nb * 32;
            const int bj = n0 >> 10, rr = n0 & 1023, drow = 256 * (rr >> 7) + 128 * bj + (rr & 127);
            p0_transpose_item(F.in[11] + (size_t)e * 1024 * 2048, 1024, 2048, WSP(bf16, WS_WGU) + (size_t)e * 2048 * 1024, kb * 64, n0, drow, nullptr, scr, lane); continue; } r -= NEXP * I_GU;
        { const int e = r / I_DN, q = r % I_DN, kb = q / 32, nb = q % 32;
            p0_transpose_item(F.in[13] + (size_t)e * 1024 * 1024, 1024, 1024, WSP(bf16, WS_WDN) + (size_t)e * 1024 * 1024, kb * 64, nb * 32, nb * 32, nullptr, scr, lane); }
    }
    for (int m = gw; m < T; m += NGW) rms_row_to_bf16(F.in[0] + (size_t)m * D, F.in[2], WSP(bf16, WS_XN) + (size_t)m * D, lane);
    if (F.vcu == 0 && F.tid < 64) WSP(int, WS_CTL)[F.tid] = 0;
    if (gw == 0) { u32x4 z = {0u, 0u, 0u, 0u}; u32x4* zr = (u32x4*)(WSP(bf16, WS_XN) + (size_t)T * D); zr[lane] = z; zr[lane + 64] = z; }
    { const size_t gt = (size_t)(F.vcu * 512 + F.tid), NT = (size_t)F.G * 512; const f32x4* ps = (const f32x4*)F.in[1]; u32x2* pd = (u32x2*)WSP(bf16, WS_PBF);
      for (size_t i = gt; i < (size_t)T * PLE / 4; i += NT) { const f32x4 v = ps[i]; u32x2 o; o.x = cvt_pk_bf16(v.x, v.y); o.y = cvt_pk_bf16(v.z, v.w); pd[i] = o; } }
    { const int gt = F.vcu * 512 + F.tid, NT = F.G * 512; float* COS = WSP(float, WS_TAB); float* SIN = COS + SEQ * 128;
      for (int i = gt; i < SEQ * 128; i += NT) { const int pos = i >> 7, j = i & 127;
        const float lin = (float)j / 127.0f; const float inv = exp2f(-lin * 13.287712379549449f);
        const float ang = (float)pos * inv;
        double rev = (double)ang * 0.15915494309189535; rev -= __builtin_floor(rev);
        const float rf = (float)rev;
        COS[i] = __builtin_amdgcn_cosf(rf); SIN[i] = __builtin_amdgcn_sinf(rf); } }
}

__device__ __forceinline__ void phase_pool(Frame& F) {
    const bf16* UP = (const bf16*)(F.ws + WS_BIG + B_UP); bf16* PO = WSP(bf16, WS_XN);
    const int gt = F.vcu * 512 + F.tid, NTH = F.G * 512;
    for (int task = gt; task < (T / 32) * 128; task += NTH) {
        const int c8 = task & 127, strip = task >> 7, row0 = strip * 32, t0 = row0 & (SEQ - 1);
        const int w = 2 << (c8 >> 5);
        float sum[8];
#pragma unroll
        for (int e = 0; e < 8; ++e) sum[e] = 0.f;
        for (int i = 1; i < w; ++i) { if (t0 - i >= 0) { const u32x4 v = *(const u32x4*)(UP + (size_t)(row0 - i) * D + c8 * 8);
            sum[0] += bflo(v.x); sum[1] += bfhi(v.x); sum[2] += bflo(v.y); sum[3] += bfhi(v.y); sum[4] += bflo(v.z); sum[5] += bfhi(v.z); sum[6] += bflo(v.w); sum[7] += bfhi(v.w); } }
        for (int tt = 0; tt < 32; ++tt) {
            const int t = t0 + tt; const size_t ro = (size_t)(row0 + tt) * D + c8 * 8;
            const u32x4 v = *(const u32x4*)(UP + ro);
            float cu[8] = {bflo(v.x), bfhi(v.x), bflo(v.y), bfhi(v.y), bflo(v.z), bfhi(v.z), bflo(v.w), bfhi(v.w)};
#pragma unroll
            for (int e = 0; e < 8; ++e) sum[e] += cu[e];
            const float ic = 1.0f / (float)(t + 1 < w ? t + 1 : w);
            u32x4 r; r.x = cvt_pk_bf16(sum[0] * ic - cu[0], sum[1] * ic - cu[1]); r.y = cvt_pk_bf16(sum[2] * ic - cu[2], sum[3] * ic - cu[3]);
            r.z = cvt_pk_bf16(sum[4] * ic - cu[4], sum[5] * ic - cu[5]); r.w = cvt_pk_bf16(sum[6] * ic - cu[6], sum[7] * ic - cu[7]);
            *(u32x4*)(PO + ro) = r;
            if (t - w + 1 >= 0) { const u32x4 o = *(const u32x4*)(UP + ro - (size_t)(w - 1) * D);
                sum[0] -= bflo(o.x); sum[1] -= bfhi(o.x); sum[2] -= bflo(o.y); sum[3] -= bfhi(o.y); sum[4] -= bflo(o.z); sum[5] -= bfhi(o.z); sum[6] -= bflo(o.w); sum[7] -= bfhi(o.w); }
        }
    }
}

constexpr int RQ = 528, RVS = 144, RP = 144, RS = 528;
constexpr int QOFF = 0, KOFF = QOFF + 64 * RQ, VOFF = KOFF + 64 * RQ, V2OFF = VOFF + 64 * RVS, POFF = V2OFF + 64 * RVS, SOFF = POFF + 64 * RP, RET_END = SOFF + 64 * RS;
static_assert(RET_END <= RING_BYTES, "retention LDS");
typedef short v4i16_t __attribute__((ext_vector_type(4)));
__device__ __forceinline__ bf16x8 ld128(LAS const unsigned char* p) { return *(const LAS bf16x8*)p; }
__device__ __forceinline__ bf16x8 trfrag(LAS const unsigned char* base, int pitch, int k0, int c0, int g, int q4, int p4) {
    LAS const unsigned char* a = base + pitch * (k0 + 8 * g + q4) + (c0 + 4 * p4) * 2;
    const v4i16_t lo = __builtin_amdgcn_ds_read_tr16_b64_v4i16((LAS v4i16_t*)a);
    const v4i16_t hi = __builtin_amdgcn_ds_read_tr16_b64_v4i16((LAS v4i16_t*)(a + 4 * pitch));
    return __builtin_shufflevector(lo, hi, 0, 1, 2, 3, 4, 5, 6, 7);
}
__device__ __forceinline__ void retention_unit(Frame& F, int b, int h, int s) {
    LAS unsigned char* lds = F.lds;
    const int tid = F.tid, lane = F.lane, w = F.wave, r = lane & 15, g = lane >> 4, q4 = (lane & 15) >> 2, p4 = lane & 3;
    const bf16* Qg = (const bf16*)(F.ws + WS_BIG + B_Q); const bf16* Kg = (const bf16*)(F.ws + WS_BIG + B_K);
    bf16* Vg = (bf16*)(F.ws + WS_BIG + B_V); const bf16* Gg = (const bf16*)(F.ws + WS_BIG + B_GR); float* SSQ = WSP(float, WS_SSQ);
    const float lg2 = log2f(1.0f - exp2f(-5.0f - (float)h));
    const int ti = w >> 1, th = w & 1;
    float dec[2][4];
#pragma unroll
    for (int t = 0; t < 2; ++t)
#pragma unroll
        for (int e = 0; e < 4; ++e) dec[t][e] = exp2f(lg2 * fabsf((float)(16 * ti + r - (16 * (2 * th + t) + 4 * g + e))));
    const float qdec = exp2f(lg2 * (float)(16 * ti + r + 1)), cdec = exp2f(lg2 * 64.0f), kdec = exp2f(lg2 * (float)(63 - (tid >> 3)));
    f32x4 st[2][4];
#pragma unroll
    for (int a = 0; a < 2; ++a)
#pragma unroll
        for (int d = 0; d < 4; ++d) st[a][d] = (f32x4){0.f, 0.f, 0.f, 0.f};
    for (int i = tid; i < 64 * RS / 16; i += 512) *(LAS u32x4*)(lds + SOFF + i * 16) = (u32x4){0u, 0u, 0u, 0u};
    const size_t tokb = (size_t)b * SEQ;
    u32x4 pq[4], pk[4], pv; u32x2 pg[2];
#define RET_LOAD(c) do { const size_t t0_ = tokb + (size_t)(c) * 64; \
        _Pragma("unroll") for (int i = 0; i < 4; ++i) { const int p_ = tid + 512 * i; const size_t e_ = (t0_ + (p_ >> 5)) * 1024 + 256 * h + (p_ & 31) * 8; pq[i] = *(const u32x4*)(Qg + e_); pk[i] = *(const u32x4*)(Kg + e_); } \
        pv = *(const u32x4*)(Vg + (t0_ + (tid >> 3)) * 2048 + 512 * h + 64 * s + (tid & 7) * 8); } while (0)
#define RET_STORE() do { \
        _Pragma("unroll") for (int i = 0; i < 4; ++i) { const int p_ = tid + 512 * i; *(LAS u32x4*)(lds + QOFF + (p_ >> 5) * RQ + (p_ & 31) * 16) = pq[i]; *(LAS u32x4*)(lds + KOFF + (p_ >> 5) * RQ + (p_ & 31) * 16) = pk[i]; } \
        *(LAS u32x4*)(lds + VOFF + (tid >> 3) * RVS + (tid & 7) * 16) = pv; \
        u32x4 v2_; v2_.x = cvt_pk_bf16(bflo(pv.x) * kdec, bfhi(pv.x) * kdec); v2_.y = cvt_pk_bf16(bflo(pv.y) * kdec, bfhi(pv.y) * kdec); v2_.z = cvt_pk_bf16(bflo(pv.z) * kdec, bfhi(pv.z) * kdec); v2_.w = cvt_pk_bf16(bflo(pv.w) * kdec, bfhi(pv.w) * kdec); \
        *(LAS u32x4*)(lds + V2OFF + (tid >> 3) * RVS + (tid & 7) * 16) = v2_; } while (0)
    RET_LOAD(0);
    RET_STORE();
    __syncthreads();
    for (int c = 0; c < SEQ / 64; ++c) {
        const size_t t0 = tokb + (size_t)c * 64;
#pragma unroll
        for (int t = 0; t < 2; ++t) pg[t] = *(const u32x2*)(Gg + (t0 + 16 * ti + r) * 2048 + 512 * h + 64 * s + 16 * (2 * th + t) + 4 * g);
        if (c + 1 < SEQ / 64) RET_LOAD(c + 1);
        bf16x8 bq[8];
#pragma unroll
        for (int ks = 0; ks < 8; ++ks) bq[ks] = ld128(lds + QOFF + (16 * ti + r) * RQ + (32 * ks + 8 * g) * 2);
        f32x4 S[2] = {(f32x4){0.f, 0.f, 0.f, 0.f}, (f32x4){0.f, 0.f, 0.f, 0.f}};
#pragma unroll
        for (int ks = 0; ks < 8; ++ks)
#pragma unroll
            for (int t = 0; t < 2; ++t) { const bf16x8 ak = ld128(lds + KOFF + (16 * (2 * th + t) + r) * RQ + (32 * ks + 8 * g) * 2); S[t] = __builtin_amdgcn_mfma_f32_16x16x32_bf16(ak, bq[ks], S[t], 0, 0, 0); }
#pragma unroll
        for (int t = 0; t < 2; ++t) { u32x2 pw; pw.x = cvt_pk_bf16(S[t][0] * dec[t][0], S[t][1] * dec[t][1]); pw.y = cvt_pk_bf16(S[t][2] * dec[t][2], S[t][3] * dec[t][3]);
            *(LAS u32x2*)(lds + POFF + (16 * ti + r) * RP + (16 * (2 * th + t) + 4 * g) * 2) = pw; }
        __syncthreads();
        f32x4 oPV[2] = {(f32x4){0.f, 0.f, 0.f, 0.f}, (f32x4){0.f, 0.f, 0.f, 0.f}}, oQS[2] = {(f32x4){0.f, 0.f, 0.f, 0.f}, (f32x4){0.f, 0.f, 0.f, 0.f}};
#pragma unroll
        for (int ks = 0; ks < 2; ++ks) { const bf16x8 bp = ld128(lds + POFF + (16 * ti + r) * RP + (32 * ks + 8 * g) * 2);
#pragma unroll
            for (int t = 0; t < 2; ++t) { const bf16x8 av = trfrag(lds + VOFF, RVS, 32 * ks, 16 * (2 * th + t), g, q4, p4); oPV[t] = __builtin_amdgcn_mfma_f32_16x16x32_bf16(av, bp, oPV[t], 0, 0, 0); } }
#pragma unroll
        for (int ks = 0; ks < 8; ++ks)
#pragma unroll
            for (int t = 0; t < 2; ++t) { const bf16x8 as = ld128(lds + SOFF + (16 * (2 * th + t) + r) * RS + (32 * ks + 8 * g) * 2); oQS[t] = __builtin_amdgcn_mfma_f32_16x16x32_bf16(as, bq[ks], oQS[t], 0, 0, 0); }
        float ss = 0.f;
#pragma unroll
        for (int t = 0; t < 2; ++t) {
            const f32x4 o = oPV[t] + oQS[t] * qdec;
            ss += (o[0] * o[0] + o[1] * o[1]) + (o[2] * o[2] + o[3] * o[3]);
            const float g0 = bflo(pg[t].x), g1 = bfhi(pg[t].x), g2 = bflo(pg[t].y), g3 = bfhi(pg[t].y);
            u32x2 ow; ow.x = cvt_pk_bf16(o[0] * g0 * sigmoidf_(g0), o[1] * g1 * sigmoidf_(g1)); ow.y = cvt_pk_bf16(o[2] * g2 * sigmoidf_(g2), o[3] * g3 * sigmoidf_(g3));
            *(u32x2*)(Vg + (t0 + 16 * ti + r) * 2048 + 512 * h + 64 * s + 16 * (2 * th + t) + 4 * g) = ow;
        }
        ss += __shfl_xor(ss, 16); ss += __shfl_xor(ss, 32);
        if (g == 0) SSQ[((t0 + 16 * ti + r) * 4 + h) * 16 + 2 * s + th] = ss;
#pragma unroll
        for (int a = 0; a < 2; ++a)
#pragma unroll
            for (int d = 0; d < 4; ++d) st[a][d] = st[a][d] * cdec;
#pragma unroll
        for (int ks = 0; ks < 2; ++ks) {
            bf16x8 akk[2];
#pragma unroll
            for (int a = 0; a < 2; ++a) akk[a] = trfrag(lds + KOFF, RQ, 32 * ks, 16 * (2 * w + a), g, q4, p4);
#pragma unroll
            for (int d = 0; d < 4; ++d) { const bf16x8 bv = trfrag(lds + V2OFF, RVS, 32 * ks, 16 * d, g, q4, p4);
#pragma unroll
                for (int a = 0; a < 2; ++a) st[a][d] = __builtin_amdgcn_mfma_f32_16x16x32_bf16(akk[a], bv, st[a][d], 0, 0, 0); }
        }
        __syncthreads();
#pragma unroll
        for (int a = 0; a < 2; ++a)
#pragma unroll
            for (int d = 0; d < 4; ++d) { u32x2 sw; sw.x = cvt_pk_bf16(st[a][d][0], st[a][d][1]); sw.y = cvt_pk_bf16(st[a][d][2], st[a][d][3]);
                *(LAS u32x2*)(lds + SOFF + (16 * d + r) * RS + (16 * (2 * w + a) + 4 * g) * 2) = sw; }
        if (c + 1 < SEQ / 64) RET_STORE();
        __syncthreads();
    }
#undef RET_LOAD
#undef RET_STORE
}

__device__ __forceinline__ void phase_onorm(Frame& F) {
    bf16* O = (bf16*)(F.ws + WS_BIG + B_V); const float* SSQ = WSP(float, WS_SSQ);
    const int gw = F.vcu * 8 + F.wave, NGW = F.G * 8, lane = F.lane;
    for (int m = gw; m < T; m += NGW) {
        const float sv = SSQ[(size_t)m * 64 + lane];
        float hs = sv; hs += __shfl_xor(hs, 1); hs += __shfl_xor(hs, 2); hs += __shfl_xor(hs, 4); hs += __shfl_xor(hs, 8);
        const float rs = rsqrtf(hs * (1.0f / 512.0f) + EPS);
        u32x4* row = (u32x4*)(O + (size_t)m * RV_W);
#pragma unroll
        for (int j = 0; j < 4; ++j) {
            const float rj = __shfl(rs, j * 16);
            u32x4 v = row[j * 64 + lane];
            v.x = cvt_pk_bf16(bflo(v.x) * rj, bfhi(v.x) * rj); v.y = cvt_pk_bf16(bflo(v.y) * rj, bfhi(v.y) * rj); v.z = cvt_pk_bf16(bflo(v.z) * rj, bfhi(v.z) * rj); v.w = cvt_pk_bf16(bflo(v.w) * rj, bfhi(v.w) * rj);
            row[j * 64 + lane] = v;
        }
    }
}

__device__ __forceinline__ void phase_route(Frame& F) {
    LAS unsigned char* lds = F.lds; const int tid = F.tid, lane = F.lane, w = F.wave;
    LAS float* WT = (LAS float*)lds;
    LAS int* hist = (LAS int*)(lds + RT_MISC); LAS int* base = hist + 32; LAS unsigned* ent = (LAS unsigned*)(base + 32); LAS float* entw = (LAS float*)(ent + 512);
    const float* wr_ = F.in[9]; const float* br_ = F.in[10];
    for (int i = tid; i < 1024 * 32 / 4; i += 512) { const int k = i >> 3, e4 = (i & 7) * 4; const int rho = ((k >> 8) * 4 + (k & 3)) * 64 + ((k >> 2) & 63);
        *(LAS f32x4*)(WT + rho * 36 + e4) = *(const f32x4*)(wr_ + k * 32 + e4); }
    if (tid < 32) hist[tid] = 0;
    __syncthreads();
    const int RPB = T / F.G, r0 = F.vcu * RPB;
    const float* X1 = F.out; bf16* H2 = WSP(bf16, WS_XN); const float* gf = F.in[8];
    f32x4 gg[4];
#pragma unroll
    for (int j = 0; j < 4; ++j) gg[j] = ((const f32x4*)gf)[64 * j + lane];
    const float myb = br_[(lane >> 1) & 31];
    for (int rl = w; rl < RPB; rl += 8) {
        const int row = r0 + rl;
        const f32x4* xr = (const f32x4*)(X1 + (size_t)row * D) + lane;
        f32x4 v[4]; float s = 0.f;
#pragma unroll
        for (int j = 0; j < 4; ++j) { v[j] = xr[64 * j]; s += (v[j].x * v[j].x + v[j].y * v[j].y) + (v[j].z * v[j].z + v[j].w * v[j].w); }
        const float rstd = rsqrtf(wave_sum(s) * (1.f / D) + EPS);
        u32x2* o8 = (u32x2*)(H2 + (size_t)row * D) + lane;
#pragma unroll
        for (int j = 0; j < 4; ++j) { v[j] = v[j] * rstd * gg[j]; u32x2 o; o.x = cvt_pk_bf16(v[j].x, v[j].y); o.y = cvt_pk_bf16(v[j].z, v[j].w); o8[64 * j] = o; }
        float pl[32];
#pragma unroll
        for (int e = 0; e < 32; ++e) pl[e] = 0.f;
#pragma unroll
        for (int j = 0; j < 4; ++j)
#pragma unroll
            for (int e4 = 0; e4 < 4; ++e4) {
                const float xv = v[j][e4]; const LAS f32x4* wrow = (const LAS f32x4*)(WT + ((j * 4 + e4) * 64 + lane) * 36);
#pragma unroll
                for (int q = 0; q < 8; ++q) { const f32x4 wv = wrow[q]; pl[4 * q] += xv * wv.x; pl[4 * q + 1] += xv * wv.y; pl[4 * q + 2] += xv * wv.z; pl[4 * q + 3] += xv * wv.w; }
            }
#define BFLY(n, msk) do { const bool hi_ = (lane & (msk)) != 0; _Pragma("unroll") for (int e = 0; e < (n) / 2; ++e) { const float keep_ = hi_ ? pl[e + (n) / 2] : pl[e]; const float send_ = hi_ ? pl[e] : pl[e + (n) / 2]; pl[e] = keep_ + __shfl_xor(send_, (msk)); } } while (0)
        BFLY(32, 32); BFLY(16, 16); BFLY(8, 8); BFLY(4, 4); BFLY(2, 2);
#undef BFLY
        float lg = pl[0] + __shfl_xor(pl[0], 1) + myb;
        const int myE = (lane >> 1) & 31;
        float cand = (lane & 1) ? -3.0e38f : lg;
        float selv[4]; int seli[4];
#pragma unroll
        for (int k = 0; k < 4; ++k) {
            float bv = cand; int bi = myE;
#pragma unroll
            for (int o = 1; o < 64; o <<= 1) { const float ov = __shfl_xor(bv, o); const int oi = __shfl_xor(bi, o); if (ov > bv || (ov == bv && oi < bi)) { bv = ov; bi = oi; } }
            selv[k] = bv; seli[k] = bi; if (myE == bi) cand = -3.0e38f;
        }
        const float e1 = __expf(selv[1] - selv[0]), e2 = __expf(selv[2] - selv[0]), e3 = __expf(selv[3] - selv[0]);
        const float inv = 1.0f / (1.0f + e1 + e2 + e3);
        if (lane < 4) {
            const int ek = lane == 0 ? seli[0] : lane == 1 ? seli[1] : lane == 2 ? seli[2] : seli[3];
            const float gk = (lane == 0 ? 1.0f : lane == 1 ? e1 : lane == 2 ? e2 : e3) * inv;
            const int lr = __hip_atomic_fetch_add(&hist[ek], 1, __ATOMIC_RELAXED, __HIP_MEMORY_SCOPE_WORKGROUP);
            ent[rl * 4 + lane] = ((unsigned)ek << 16) | (unsigned)lr; entw[rl * 4 + lane] = gk;
        }
    }
    __syncthreads();
    int* counts = WSP(int, WS_CTL);
    if (tid < 32) base[tid] = __hip_atomic_fetch_add(counts + tid, hist[tid], __ATOMIC_RELAXED, __HIP_MEMORY_SCOPE_AGENT);
    __syncthreads();
    int* TOKE = WSP(int, WS_TOKE); float* GATEE = WSP(float, WS_GATEE); unsigned* ROUTE = WSP(unsigned, WS_ROUTE);
    for (int i = tid; i < RPB * 4; i += 512) {
        const unsigned en = ent[i]; const int e = en >> 16, rank = base[e] + (int)(en & 0xffffu); const int tok = r0 + (i >> 2);
        TOKE[(size_t)e * T + rank] = tok; GATEE[(size_t)e * T + rank] = entw[i]; ROUTE[(size_t)tok * 4 + (i & 3)] = ((unsigned)e << 16) | (unsigned)rank;
    }
}

__device__ __forceinline__ int build_tiles(Frame& F) {
    LAS int* tile_e = (LAS int*)(F.lds + MISC_TILEE); LAS int* tbase = (LAS int*)(F.lds + MISC_TBASE); LAS int* cnt = (LAS int*)(F.lds + MISC_CNT);
    const int* counts = WSP(int, WS_CTL);
    __syncthreads();
    if (F.tid < 32) cnt[F.tid] = __hip_atomic_load(counts + F.tid, __ATOMIC_RELAXED, __HIP_MEMORY_SCOPE_AGENT);
    __syncthreads();
    if (F.tid == 0) { int a = 0; for (int e = 0; e < 32; ++e) { tbase[e] = a; a += (cnt[e] + 255) >> 8; } tbase[32] = a; }
    __syncthreads();
    const int nt = tbase[32];
    for (int t = F.tid; t < nt; t += 512) { int e = 0; for (int q = 1; q < 32; ++q) e += (tbase[q] <= t) ? 1 : 0; tile_e[t] = e; }
    __syncthreads();
    return nt;
}

__device__ __forceinline__ void phase_combine(Frame& F, int  ) {
    LAS const int* tbase = (LAS const int*)(F.lds + MISC_TBASE);
    const bf16* Y = (const bf16*)(F.ws + WS_BIG + B_Y); const unsigned* ROUTE = WSP(unsigned, WS_ROUTE); float* X = F.out; bf16* U = WSP(bf16, WS_XN); const float* gp = F.in[15];
    const int gw = F.vcu * 8 + F.wave, NGW = F.G * 8, lane = F.lane;
    for (int m = gw; m < T; m += NGW) {
        f32x4 v[4]; f32x4* xr = (f32x4*)(X + (size_t)m * D);
#pragma unroll
        for (int jj = 0; jj < 2; ++jj) { v[2 * jj] = xr[2 * lane + 128 * jj]; v[2 * jj + 1] = xr[2 * lane + 128 * jj + 1]; }
#pragma unroll
        for (int k = 0; k < 4; ++k) {
            const unsigned er = ROUTE[(size_t)m * 4 + k]; const int e = er >> 16, rank = er & 0xffffu;
            const size_t pos = (size_t)tbase[e] * 256 + rank;
            const u32x4* yr = (const u32x4*)(Y + pos * D);
#pragma unroll
            for (int jj = 0; jj < 2; ++jj) { const u32x4 y = yr[lane + 64 * jj];
                v[2 * jj][0] += bflo(y.x); v[2 * jj][1] += bfhi(y.x); v[2 * jj][2] += bflo(y.y); v[2 * jj][3] += bfhi(y.y);
                v[2 * jj + 1][0] += bflo(y.z); v[2 * jj + 1][1] += bfhi(y.z); v[2 * jj + 1][2] += bflo(y.w); v[2 * jj + 1][3] += bfhi(y.w); }
        }
        float s = 0.f;
#pragma unroll
        for (int j = 0; j < 4; ++j) s += (v[j].x * v[j].x + v[j].y * v[j].y) + (v[j].z * v[j].z + v[j].w * v[j].w);
        const float rstd = rsqrtf(wave_sum(s) * (1.f / D) + EPS);
        u32x4* ur = (u32x4*)(U + (size_t)m * D);
#pragma unroll
        for (int jj = 0; jj < 2; ++jj) {
            xr[2 * lane + 128 * jj] = v[2 * jj]; xr[2 * lane + 128 * jj + 1] = v[2 * jj + 1];
            const f32x4 g0 = ((const f32x4*)gp)[2 * lane + 128 * jj], g1 = ((const f32x4*)gp)[2 * lane + 128 * jj + 1];
            const f32x4 a = v[2 * jj] * rstd * g0, bq = v[2 * jj + 1] * rstd * g1;
            u32x4 o; o.x = cvt_pk_bf16(a[0], a[1]); o.y = cvt_pk_bf16(a[2], a[3]); o.z = cvt_pk_bf16(bq[0], bq[1]); o.w = cvt_pk_bf16(bq[2], bq[3]);
            ur[lane + 64 * jj] = o;
        }
    }
}

__device__ __forceinline__ void phase_final(Frame& F) {
    const int gw = F.vcu * 8 + F.wave, NGW = F.G * 8, lane = F.lane; const float* gfin = F.in[18];
    for (int m = gw; m < T; m += NGW) {
        f32x4* xr = (f32x4*)(F.out + (size_t)m * D) + lane; f32x4 v[4]; float s = 0.f;
#pragma unroll
        for (int j = 0; j < 4; ++j) { v[j] = xr[64 * j]; s += (v[j].x * v[j].x + v[j].y * v[j].y) + (v[j].z * v[j].z + v[j].w * v[j].w); }
        const float rstd = rsqrtf(wave_sum(s) * (1.f / D) + EPS);
#pragma unroll
        for (int j = 0; j < 4; ++j) xr[64 * j] = v[j] * rstd * ((const f32x4*)gfin)[64 * j + lane];
    }
}

__global__ void __launch_bounds__(512, 2) fwd(Args args) {
    extern __shared__ __attribute__((aligned(16))) unsigned char lds_raw[];
    Frame F;
    F.lds = (LAS unsigned char*)lds_raw; F.tid = threadIdx.x; F.lane = F.tid & 63; F.wave = __builtin_amdgcn_readfirstlane(F.tid >> 6);
    F.G = gridDim.x; { const int bx = blockIdx.x; F.vcu = (F.G % 8 == 0) ? (bx % 8) * (F.G / 8) + bx / 8 : bx; }
#pragma unroll
    for (int i = 0; i < 19; ++i) F.in[i] = args.in[i];
    F.out = args.out; F.ws = args.ws;
    const int lo = args.ph_lo, hi = args.ph_hi;
    cg::grid_group grid = cg::this_grid();
#define IN(k) (lo <= (k) && (k) < hi)
#define SEAM(k) do { if (IN(k) && IN((k) + 1)) grid.sync(); } while (0)
    unsigned char* big = F.ws + WS_BIG;

    if (IN(0)) { phase0(F); } SEAM(0);

    if (IN(1)) {
        { pg8::SchedDense S; S.init(T / 256, INW / 256, F.G, (int)blockIdx.x); S.A = (const char*)(F.ws + WS_XN); S.Bt = (const char*)(F.ws + WS_WIN); S.lda = 1024; S.K = 1024; S.acol_per_pn = 0;
          pg8::EpiProj E{(bf16*)big, WSP(float, WS_TAB), WSP(float, WS_TAB) + SEQ * 128};
          pg8::gemm_phase<pg8::EpiProj, pg8::SchedDense>(F.lds, 1024, S, E); }
        { pg8::SchedDense S; S.init(T / 256, 4, F.G, (int)blockIdx.x); S.A = (const char*)(F.ws + WS_PBF); S.Bt = (const char*)(F.ws + WS_WPLE); S.lda = 256; S.K = 256; S.acol_per_pn = 0;
          pg8::EpiGated E{WSP(bf16, WS_PE), nullptr, nullptr};
          pg8::gemm_phase<pg8::EpiGated, pg8::SchedDense>(F.lds, 256, S, E); }
    } SEAM(1);

    if (IN(2)) {
        phase_pool(F);
        __syncthreads();
        for (int uid = F.vcu; uid < BATCH * 4 * 8; uid += F.G) { retention_unit(F, uid >> 5, (uid >> 3) & 3, uid & 7); __syncthreads(); }
    } SEAM(2);

    if (IN(3)) { phase_onorm(F); } SEAM(3);

    if (IN(4)) {
        pg8::SchedDense S; S.init(T / 256, 4, F.G, (int)blockIdx.x); S.A = (const char*)(F.ws + WS_XN); S.Bt = (const char*)(F.ws + WS_WPOOL); S.lda = 1024; S.K = 256; S.acol_per_pn = 256;
        pg8::EpiGated E{(bf16*)(big + B_UP), nullptr, (const bf16*)(big + B_GA)};
        pg8::gemm_phase<pg8::EpiGated, pg8::SchedDense>(F.lds, 256, S, E);
    } SEAM(4);

    if (IN(5)) {
        pg8::SchedDense S; S.init(T / 256, 4, F.G, (int)blockIdx.x); S.A = (const char*)(big + B_V); S.Bt = (const char*)(F.ws + WS_WRETO); S.lda = 2048; S.K = 2048; S.acol_per_pn = 0;
        pg8::EpiGated E{WSP(bf16, WS_XN), (const bf16*)(big + B_UP), (const bf16*)(big + B_GB)};
        pg8::gemm_phase<pg8::EpiGated, pg8::SchedDense>(F.lds, 2048, S, E);
    } SEAM(5);

    if (IN(6)) {
        pg8::SchedDense S; S.init(T / 256, 4, F.G, (int)blockIdx.x); S.A = (const char*)(F.ws + WS_XN); S.Bt = (const char*)(F.ws + WS_WOUT); S.lda = 1024; S.K = 1024; S.acol_per_pn = 0;
        pg8::EpiResF32 E{F.in[0], F.out, nullptr};
        pg8::gemm_phase<pg8::EpiResF32, pg8::SchedDense>(F.lds, 1024, S, E);
    } SEAM(6);

    if (IN(7)) { phase_route(F); } SEAM(7);

    if (IN(8)) {
        const int ntl = build_tiles(F);
        pg8::SchedMoe S; S.init(ntl, 8, F.G, (int)blockIdx.x); S.A = (const char*)(F.ws + WS_XN); S.Bt = (const char*)(F.ws + WS_WGU); S.K = 1024; S.nrowsB = 2048; S.tok_e = WSP(int, WS_TOKE);
        S.tile_e = (LAS const int*)(F.lds + MISC_TILEE); S.tbase = (LAS const int*)(F.lds + MISC_TBASE); S.cnt = (LAS const int*)(F.lds + MISC_CNT);
        pg8::EpiGateUp E{(bf16*)(big + B_ACT), F.in[12]};
        pg8::gemm_phase<pg8::EpiGateUp, pg8::SchedMoe>(F.lds, 1024, S, E);
    } SEAM(8);

    if (IN(9)) {
        const int ntl = build_tiles(F);
        pg8::SchedMoe S; S.init(ntl, 4, F.G, (int)blockIdx.x); S.A = (const char*)(big + B_ACT); S.Bt = (const char*)(F.ws + WS_WDN); S.K = 1024; S.nrowsB = 1024; S.tok_e = nullptr;
        S.tile_e = (LAS const int*)(F.lds + MISC_TILEE); S.tbase = (LAS const int*)(F.lds + MISC_TBASE); S.cnt = (LAS const int*)(F.lds + MISC_CNT);
        pg8::EpiDown E{(bf16*)(big + B_Y), F.in[14], WSP(float, WS_GATEE), S.tbase, S.cnt};
        pg8::gemm_phase<pg8::EpiDown, pg8::SchedMoe>(F.lds, 1024, S, E);
    } SEAM(9);

    if (IN(10)) { const int ntl = build_tiles(F); phase_combine(F, ntl); } SEAM(10);

    if (IN(11)) {
        pg8::SchedDense S; S.init(T / 256, 4, F.G, (int)blockIdx.x); S.A = (const char*)(F.ws + WS_XN); S.Bt = (const char*)(F.ws + WS_WPG); S.lda = 1024; S.K = 1024; S.acol_per_pn = 0;
        pg8::EpiResF32 E{F.out, F.out, WSP(bf16, WS_PE)};
        pg8::gemm_phase<pg8::EpiResF32, pg8::SchedDense>(F.lds, 1024, S, E);
    } SEAM(11);

    if (IN(12)) { phase_final(F); }
#undef IN
#undef SEAM
}


#ifdef PROBE_DET
__global__ void ck_sum(const unsigned* p, size_t nwords, unsigned long long* out, const int* counts) {
    if (counts) { int nt = 0; for (int e = 0; e < 32; ++e) nt += (counts[e] + 255) >> 8; nwords = (size_t)nt * 256 * 512; }
    unsigned long long s = 0;
    for (size_t i = (size_t)blockIdx.x * blockDim.x + threadIdx.x; i < nwords; i += (size_t)gridDim.x * blockDim.x) s += p[i];
    for (int o = 32; o >= 1; o >>= 1) s += __shfl_xor(s, o);
    if ((threadIdx.x & 63) == 0) atomicAdd(out, s);
}
__global__ void ck_final(const unsigned long long* ck, float* out, size_t n) {
    int first = -1;
    for (int p = 0; p < 13 && first < 0; ++p) for (int k = 0; k < 4; ++k) if (ck[(0 * 13 + p) * 4 + k] != ck[(1 * 13 + p) * 4 + k]) { first = p * 4 + k; break; }
    const float v = first < 0 ? 0.0f : sqrtf((float)(first + 1));
    for (size_t i = (size_t)blockIdx.x * blockDim.x + threadIdx.x; i < n; i += (size_t)gridDim.x * blockDim.x) out[i] = v;
}
#endif

extern "C" void kernel_launch(void* const* d_in, const int* in_sizes, int n_in, void* d_out, int out_size, void* d_ws, size_t ws_size, hipStream_t stream) {
    static int grid = 0;
    if (grid == 0) {
        if (n_in != 19 || in_sizes[0] != T * D || out_size != T * D || ws_size < WS_END) {
            fprintf(stderr, "kernel_launch: unexpected shapes (n_in %d, in0 %d, out %d, ws %zu, need %zu); nothing launched\n", n_in, n_in > 0 ? in_sizes[0] : -1, out_size, ws_size, (size_t)WS_END); grid = -1; return; }
        int dev = 0, cus = 0, per_cu = 0;
        if (hipGetDevice(&dev) != hipSuccess || hipDeviceGetAttribute(&cus, hipDeviceAttributeMultiprocessorCount, dev) != hipSuccess) { fprintf(stderr, "kernel_launch: device query failed\n"); grid = -1; return; }
        if (hipFuncSetAttribute((const void*)fwd, hipFuncAttributeMaxDynamicSharedMemorySize, LDS_BYTES) != hipSuccess) { fprintf(stderr, "kernel_launch: hipFuncSetAttribute failed\n"); grid = -1; return; }
        if (hipOccupancyMaxActiveBlocksPerMultiprocessor(&per_cu, (const void*)fwd, 512, LDS_BYTES) != hipSuccess || per_cu < 1) { fprintf(stderr, "kernel_launch: occupancy query says %d blocks per CU\n", per_cu); (void)hipGetLastError(); grid = -1; return; }
        grid = cus;
        if (T % grid != 0 || T / grid > 128) { fprintf(stderr, "kernel_launch: grid %d unsupported by the routing phase\n", grid); grid = -1; return; }
    }
    if (grid < 0) return;
    Args a{};
    for (int i = 0; i < 19; ++i) a.in[i] = (const float*)d_in[i];
    a.out = (float*)d_out; a.ws = (unsigned char*)d_ws;
#if MK_N_LAUNCHES == 1
    a.ph_lo = 0; a.ph_hi = N_PHASES;
    void* kargs[] = {&a};
    hipError_t e = hipLaunchCooperativeKernel((const void*)fwd, dim3(grid), dim3(512), kargs, LDS_BYTES, stream);
    if (e != hipSuccess) fprintf(stderr, "kernel_launch: cooperative launch failed: %s (grid %d)\n", hipGetErrorString(e), grid);
#else
#ifdef PROBE_DET
    unsigned char* ws = (unsigned char*)d_ws; unsigned long long* ck = (unsigned long long*)(ws + WS_CTL + 1024);
    (void)hipMemsetAsync(ck, 0, 2 * 13 * 4 * 8, stream);
    for (int pass = 0; pass < 2; ++pass) for (int p = 0; p < N_PHASES; ++p) {
        a.ph_lo = p; a.ph_hi = p + 1; hipLaunchKernelGGL(fwd, dim3(grid), dim3(512), LDS_BYTES, stream, a);
        unsigned long long* c = ck + (pass * 13 + p) * 4;
#define CK(off, bytes, slot, cnts) hipLaunchKernelGGL(ck_sum, dim3(2048), dim3(256), 0, stream, (const unsigned*)(ws + (off)), (size_t)(bytes) / 4, c + (slot), (const int*)(cnts))
        switch (p) {
            case 0: CK(WS_WIN, WS_XN - WS_WIN, 0, nullptr); CK(WS_XN, (size_t)T * D * 2, 1, nullptr); CK(WS_PBF, 16 * MiB, 2, nullptr); CK(WS_TAB, 4 * MiB, 3, nullptr); break;
            case 1: CK(WS_BIG, B_END, 0, nullptr); CK(WS_PE, 64 * MiB, 1, nullptr); break;
            case 2: CK(WS_XN, (size_t)T * D * 2, 0, nullptr); CK(WS_BIG + B_V, 128 * MiB, 1, nullptr); CK(WS_SSQ, 8 * MiB, 2, nullptr); break;
            case 3: CK(WS_BIG + B_V, 128 * MiB, 0, nullptr); break;
            case 4: CK(WS_BIG + B_UP, 64 * MiB, 0, nullptr); break;
            case 5: CK(WS_XN, (size_t)T * D * 2, 0, nullptr); break;
            case 7: CK(WS_XN, (size_t)T * D * 2, 0, nullptr); CK(WS_CTL, 128, 1, nullptr); break;
            case 8: CK(WS_BIG + B_ACT, 0, 0, ws + WS_CTL); break;
            case 9: CK(WS_BIG + B_Y, 0, 0, ws + WS_CTL); break;
            case 10: CK(WS_XN, (size_t)T * D * 2, 0, nullptr); break;
            default: break;
        }
        if (p == 6 || p == 10 || p == 11 || p == 12) hipLaunchKernelGGL(ck_sum, dim3(2048), dim3(256), 0, stream, (const unsigned*)d_out, (size_t)T * D, c + 3, (const int*)nullptr);
    }
    hipLaunchKernelGGL(ck_final, dim3(2048), dim3(256), 0, stream, (const unsigned long long*)ck, (float*)d_out, (size_t)T * D);
#else
    for (int p = 0; p < N_PHASES; ++p) { a.ph_lo = p; a.ph_hi = p + 1; hipLaunchKernelGGL(fwd, dim3(grid), dim3(512), LDS_BYTES, stream, a); }
#endif
#endif
}
```
